# Optimizing an MI355X kernel written in HIP

```python
import math
import jax, jax.numpy as jnp
from jax import lax
import numpy as np

D_MODEL = 1024
BATCH = 8
SEQ = 4096
DEPTH = 4

D_FF = 2816
GDN_HEADS = 8
GDN_DK = 128
GDN_DV = 128
CONV_K = 4
CHUNK = 64
MLA_HEADS = 8
Q_LORA = 384
KV_LORA = 256
QK_NOPE = 128
QK_ROPE = 64
V_HEAD = 128
ROPE_THETA = 10000.0
Q_BLOCK = 128
EPS = 1e-6
N_MOD = 9

GDN_QK = GDN_HEADS * GDN_DK
GDN_V = GDN_HEADS * GDN_DV
GDN_CONV_C = 2 * GDN_QK + GDN_V
MLA_QK = QK_NOPE + QK_ROPE
IN_SIZES = (GDN_CONV_C, GDN_V, GDN_HEADS, GDN_HEADS, Q_LORA, KV_LORA, QK_ROPE, D_MODEL, D_MODEL)
N_IN = GDN_CONV_C + GDN_V + 2 * GDN_HEADS + Q_LORA + KV_LORA + QK_ROPE + 2 * D_MODEL

kernel_name = 'hybrid_gdn_mla_macaron_adaln'


def rms_norm(x, gain):
    xf = x.astype(jnp.float32)
    y = xf * lax.rsqrt(jnp.mean(xf * xf, axis=-1, keepdims=True) + EPS)
    return (y * gain.astype(jnp.float32)).astype(x.dtype)


def l2_norm(x):
    xf = x.astype(jnp.float32)
    return xf * lax.rsqrt(jnp.sum(xf * xf, axis=-1, keepdims=True) + EPS)


def modulate(x, gain, shift, scale):
    return rms_norm(x, gain) * (1.0 + scale[:, None]) + shift[:, None]


def swiglu(h, w1, w3, w2):
    return (jax.nn.silu(h @ w1) * (h @ w3)) @ w2


def causal_dwconv(x, w):
    S = x.shape[1]
    xp = jnp.pad(x, ((0, 0), (CONV_K - 1, 0), (0, 0)))
    return sum(xp[:, j:j + S] * w[j] for j in range(CONV_K))


def rope_tables(positions):
    half = QK_ROPE // 2
    inv_freq = ROPE_THETA ** (-jnp.arange(half, dtype=jnp.float32) / half)
    ang = positions.astype(jnp.float32)[..., None] * inv_freq
    return jnp.cos(ang), jnp.sin(ang)


def apply_rope(x, cos, sin):
    x1, x2 = jnp.split(x, 2, axis=-1)
    c = cos[:, :, None].astype(x.dtype)
    s = sin[:, :, None].astype(x.dtype)
    return jnp.concatenate([x1 * c - x2 * s, x2 * c + x1 * s], axis=-1)


def gated_delta_rule(q, k, v, g, beta):
    B, S, H, DK = q.shape
    DV = v.shape[-1]
    N = S // CHUNK
    f32 = jnp.float32

    def chunks(t):
        t = t.astype(f32).reshape((B, N, CHUNK, H) + t.shape[3:])
        return jnp.moveaxis(t, (1, 3), (0, 2))

    qc = chunks(q) * (DK ** -0.5)
    kc, vc = chunks(k), chunks(v)
    gc, bc = chunks(g), chunks(beta)
    gcum = jnp.cumsum(gc, axis=-1)
    causal = jnp.tril(jnp.ones((CHUNK, CHUNK), bool))
    strict = jnp.tril(jnp.ones((CHUNK, CHUNK), bool), -1)
    decay = jnp.exp(jnp.where(causal, gcum[..., :, None] - gcum[..., None, :], -jnp.inf))
    kb = kc * bc[..., None]
    m = jnp.where(strict, jnp.einsum('nbhid,nbhjd->nbhij', kb, kc) * decay, 0.0)
    eye = jnp.eye(CHUNK, dtype=f32)
    t_inv = lax.linalg.triangular_solve(eye + m, jnp.broadcast_to(eye, m.shape), left_side=True, lower=True)
    u = t_inv @ (vc * bc[..., None])
    w = t_inv @ (kb * jnp.exp(gcum)[..., None])
    qk = jnp.einsum('nbhid,nbhjd->nbhij', qc, kc) * decay
    q_dec = qc * jnp.exp(gcum)[..., None]
    k_dec = kc * jnp.exp(gcum[..., -1:] - gcum)[..., None]
    g_last = jnp.exp(gcum[..., -1])

    def step(state, inp):
        u_i, w_i, qk_i, qd_i, kd_i, gl_i = inp
        v_new = u_i - w_i @ state
        o_i = qd_i @ state + qk_i @ v_new
        state = state * gl_i[..., None, None] + jnp.swapaxes(kd_i, -1, -2) @ v_new
        return state, o_i

    s0 = jnp.zeros((B, H, DK, DV), f32)
    _, o = lax.scan(step, s0, (u, w, qk, q_dec, k_dec, g_last))
    return jnp.moveaxis(o, (0, 2), (1, 3)).reshape(B, S, H, DV)


def gated_deltanet(qkv, z, b_raw, a_raw, conv_w, a_log, dt_bias, out_gain):
    B, S, _ = qkv.shape
    qkv_c = jax.nn.silu(causal_dwconv(qkv, conv_w))
    q, k, v = jnp.split(qkv_c, [GDN_QK, 2 * GDN_QK], axis=-1)
    q = l2_norm(q.reshape(B, S, GDN_HEADS, GDN_DK))
    k = l2_norm(k.reshape(B, S, GDN_HEADS, GDN_DK))
    v = v.reshape(B, S, GDN_HEADS, GDN_DV)
    beta = jax.nn.sigmoid(b_raw.astype(jnp.float32))
    g = -jnp.exp(a_log.astype(jnp.float32)) * jax.nn.softplus(a_raw.astype(jnp.float32) + dt_bias.astype(jnp.float32))
    o = gated_delta_rule(q, k, v, g, beta)
    o = rms_norm(o, out_gain) * jax.nn.silu(z.astype(jnp.float32).reshape(B, S, GDN_HEADS, GDN_DV))
    return o.reshape(B, S, GDN_V).astype(qkv.dtype)


def causal_block_attention(q, k, v):
    B, S, H, Dqk = q.shape
    nb = S // Q_BLOCK
    scale = Dqk ** -0.5
    qb = jnp.moveaxis(q.reshape(B, nb, Q_BLOCK, H, Dqk), 1, 0)
    kpos = jnp.arange(S)

    def one_block(args):
        i, q_i = args
        s = jnp.einsum('bqhd,bkhd->bhqk', q_i, k, preferred_element_type=jnp.float32) * scale
        qpos = i * Q_BLOCK + jnp.arange(Q_BLOCK)
        s = jnp.where(kpos[None, :] <= qpos[:, None], s, -jnp.inf)
        p = jax.nn.softmax(s, axis=-1)
        return jnp.einsum('bhqk,bkhv->bqhv', p.astype(v.dtype), v)

    o = lax.map(one_block, (jnp.arange(nb), qb))
    return jnp.moveaxis(o, 0, 1).reshape(B, S, H, v.shape[-1])


def mla(q_lat, kv_lat, k_pe, cos, sin, q_lat_gain, kv_lat_gain, w_q_up, w_kv_up, q_norm, k_norm):
    B, S, _ = q_lat.shape
    q = (rms_norm(q_lat, q_lat_gain) @ w_q_up).reshape(B, S, MLA_HEADS, MLA_QK)
    kv = (rms_norm(kv_lat, kv_lat_gain) @ w_kv_up).reshape(B, S, MLA_HEADS, QK_NOPE + V_HEAD)
    k_nope, v = jnp.split(kv, [QK_NOPE], axis=-1)
    k = jnp.concatenate([k_nope, jnp.broadcast_to(k_pe[:, :, None, :], (B, S, MLA_HEADS, QK_ROPE))], axis=-1)
    q = rms_norm(q, q_norm)
    k = rms_norm(k, k_norm)
    q = jnp.concatenate([q[..., :QK_NOPE], apply_rope(q[..., QK_NOPE:], cos, sin)], axis=-1)
    k = jnp.concatenate([k[..., :QK_NOPE], apply_rope(k[..., QK_NOPE:], cos, sin)], axis=-1)
    o = causal_block_attention(q, k, v)
    return o.reshape(B, S, MLA_HEADS * V_HEAD)


def token_mix(h, cos, sin, w_in, gdn_conv, gdn_a_log, gdn_dt_bias, gdn_out_gain, q_lat_gain, kv_lat_gain,
              w_q_up, w_kv_up, q_norm, k_norm, w_branch_a, w_branch_b, w_out):
    offsets = np.cumsum(IN_SIZES)[:-1].tolist()
    qkv, z, b_raw, a_raw, q_lat, kv_lat, k_pe, gate_a, gate_b = jnp.split(h @ w_in, offsets, axis=-1)
    y_a = gated_deltanet(qkv, z, b_raw, a_raw, gdn_conv, gdn_a_log, gdn_dt_bias, gdn_out_gain) @ w_branch_a
    y_b = mla(q_lat, kv_lat, k_pe, cos, sin, q_lat_gain, kv_lat_gain, w_q_up, w_kv_up, q_norm, k_norm) @ w_branch_b
    y = jax.nn.sigmoid(gate_a) * y_a + jax.nn.sigmoid(gate_b) * y_b
    return y @ w_out


def setup_inputs(seed: int = 0) -> dict:
    key = jax.random.key(seed)
    ks = iter(jax.random.split(key, 40))
    L, D = DEPTH, D_MODEL

    def normal(shape, fan_in, gain=1.0):
        return jax.random.normal(next(ks), shape, jnp.float32) * (gain * fan_in ** -0.5)

    def ones_noise(shape):
        return 1.0 + 0.05 * jax.random.normal(next(ks), shape, jnp.float32)

    x = jax.random.normal(next(ks), (BATCH, SEQ, D), jnp.float32)
    c = jax.random.normal(next(ks), (BATCH, D), jnp.float32)
    positions = (jax.random.randint(next(ks), (BATCH, 1), 0, 1024, jnp.int32)
                 + jnp.arange(SEQ, dtype=jnp.int32)[None, :])
    ada_w = normal((L, D, N_MOD * D), D, 0.25)
    ada_b = 0.01 * jax.random.normal(next(ks), (L, N_MOD * D), jnp.float32)
    norm_ffn1 = ones_noise((L, D))
    ffn1_w1 = normal((L, D, D_FF), D)
    ffn1_w3 = normal((L, D, D_FF), D)
    ffn1_w2 = normal((L, D_FF, D), D_FF)
    norm_mix = ones_noise((L, D))
    w_in = normal((L, D, N_IN), D)
    gdn_conv = normal((L, CONV_K, GDN_CONV_C), CONV_K)
    gdn_a_log = jnp.log(jax.random.uniform(next(ks), (L, GDN_HEADS), jnp.float32, 1.0, 16.0))
    dt = jnp.exp(jax.random.uniform(next(ks), (L, GDN_HEADS), jnp.float32, math.log(1e-3), math.log(1e-1)))
    gdn_dt_bias = dt + jnp.log(-jnp.expm1(-dt))
    gdn_out_gain = ones_noise((L, GDN_DV))
    mla_q_lat_gain = ones_noise((L, Q_LORA))
    mla_kv_lat_gain = ones_noise((L, KV_LORA))
    mla_w_q_up = normal((L, Q_LORA, MLA_HEADS * MLA_QK), Q_LORA)
    mla_w_kv_up = normal((L, KV_LORA, MLA_HEADS * (QK_NOPE + V_HEAD)), KV_LORA)
    mla_q_norm = ones_noise((L, MLA_QK))
    mla_k_norm = ones_noise((L, MLA_QK))
    w_branch_a = normal((L, GDN_V, D), GDN_V)
    w_branch_b = normal((L, MLA_HEADS * V_HEAD, D), MLA_HEADS * V_HEAD)
    w_out = normal((L, D, D), D)
    norm_ffn2 = ones_noise((L, D))
    ffn2_w1 = normal((L, D, D_FF), D)
    ffn2_w3 = normal((L, D, D_FF), D)
    ffn2_w2 = normal((L, D_FF, D), D_FF)
    return {'x': x, 'c': c, 'positions': positions, 'ada_w': ada_w, 'ada_b': ada_b,
            'norm_ffn1': norm_ffn1, 'ffn1_w1': ffn1_w1, 'ffn1_w3': ffn1_w3, 'ffn1_w2': ffn1_w2,
            'norm_mix': norm_mix, 'w_in': w_in, 'gdn_conv': gdn_conv, 'gdn_a_log': gdn_a_log,
            'gdn_dt_bias': gdn_dt_bias, 'gdn_out_gain': gdn_out_gain, 'mla_q_lat_gain': mla_q_lat_gain,
            'mla_kv_lat_gain': mla_kv_lat_gain, 'mla_w_q_up': mla_w_q_up, 'mla_w_kv_up': mla_w_kv_up,
            'mla_q_norm': mla_q_norm, 'mla_k_norm': mla_k_norm, 'w_branch_a': w_branch_a,
            'w_branch_b': w_branch_b, 'w_out': w_out, 'norm_ffn2': norm_ffn2, 'ffn2_w1': ffn2_w1,
            'ffn2_w3': ffn2_w3, 'ffn2_w2': ffn2_w2}


def reference(x, c, positions, ada_w, ada_b, norm_ffn1, ffn1_w1, ffn1_w3, ffn1_w2, norm_mix, w_in, gdn_conv,
              gdn_a_log, gdn_dt_bias, gdn_out_gain, mla_q_lat_gain, mla_kv_lat_gain, mla_w_q_up, mla_w_kv_up,
              mla_q_norm, mla_k_norm, w_branch_a, w_branch_b, w_out, norm_ffn2, ffn2_w1, ffn2_w3, ffn2_w2):
    cos, sin = rope_tables(positions)
    cond = jax.nn.silu(c)
    for l in range(DEPTH):
        mod = cond @ ada_w[l] + ada_b[l]
        sh1, sc1, g1, sh2, sc2, g2, sh3, sc3, g3 = jnp.split(mod, N_MOD, axis=-1)
        h = modulate(x, norm_ffn1[l], sh1, sc1)
        x = x + 0.5 * (1.0 + g1)[:, None] * swiglu(h, ffn1_w1[l], ffn1_w3[l], ffn1_w2[l])
        h = modulate(x, norm_mix[l], sh2, sc2)
        y = token_mix(h, cos, sin, w_in[l], gdn_conv[l], gdn_a_log[l], gdn_dt_bias[l], gdn_out_gain[l],
                      mla_q_lat_gain[l], mla_kv_lat_gain[l], mla_w_q_up[l], mla_w_kv_up[l], mla_q_norm[l],
                      mla_k_norm[l], w_branch_a[l], w_branch_b[l], w_out[l])
        x = x + (1.0 + g2)[:, None] * y
        h = modulate(x, norm_ffn2[l], sh3, sc3)
        x = x + 0.5 * (1.0 + g3)[:, None] * swiglu(h, ffn2_w1[l], ffn2_w3[l], ffn2_w2[l])
    return x
```

```cpp
#include <hip/hip_runtime.h>
#include <hip/hip_cooperative_groups.h>
#include <cstdio>
namespace cg = cooperative_groups;

#define DEV __device__ __forceinline__
#define LAS __attribute__((address_space(3)))
typedef unsigned short bf16_t;
typedef short bf16x8 __attribute__((ext_vector_type(8)));
typedef float f32x4 __attribute__((ext_vector_type(4)));
typedef float f32x2 __attribute__((ext_vector_type(2)));
typedef float f32x16 __attribute__((ext_vector_type(16)));
typedef unsigned u32x2 __attribute__((ext_vector_type(2)));
typedef unsigned u32x4 __attribute__((ext_vector_type(4)));

constexpr int NT = 512;
constexpr int TH = 16384;
constexpr int LDS_BYTES = 152576;

constexpr size_t OFF_MOD = 0;
constexpr size_t OFF_ROPE_C = OFF_MOD + 4ull * 8 * 9216 * 4;
constexpr size_t OFF_ROPE_S = OFF_ROPE_C + 32768ull * 32 * 4;
constexpr size_t OFF_CTR = OFF_ROPE_S + 32768ull * 32 * 4;
constexpr size_t OFF_WB = OFF_CTR + 4096;
constexpr size_t WE_13A = 0, WE_2A = 5767168, WE_IN = 8650752, WE_Q = 15728640, WE_KV = 16318464, WE_A = 16842752,
                 WE_B = 17891328, WE_O = 18939904, WE_13B = 19988480, WE_2B = 25755648, WE_END = 28639232;
constexpr size_t OFF_H = OFF_WB + WE_END * 2;
constexpr size_t OFF_BIG = OFF_H + 32768ull * 1024 * 2;
constexpr size_t OFF_ACT = OFF_BIG;
constexpr size_t OFF_QKV = OFF_BIG;
constexpr size_t OFF_ZG = OFF_QKV + 16384ull * 3072 * 2;
constexpr size_t OFF_LAT = OFF_ZG + 16384ull * 3072 * 2;
constexpr size_t OFF_GDN = OFF_LAT + 16384ull * 768 * 2;
constexpr size_t OFF_GLAST = OFF_GDN + 2048ull * 36864 * 2;
constexpr size_t OFF_QR = OFF_GLAST + 8192;
constexpr size_t OFF_KVR = OFF_QR + 16384ull * 1536 * 2;
constexpr size_t OFF_KF = OFF_KVR + 16384ull * 2048 * 2;
constexpr size_t OFF_VT = OFF_KF + 16384ull * 1536 * 2;
constexpr size_t WS_END = OFF_VT + 32ull * 128 * 4096 * 2;
constexpr int REC = 36864;

struct Params {
  const float* x; const float* c; const int* pos; const float* ada_w; const float* ada_b; const float* norm_ffn1;
  const float* f1w1; const float* f1w3; const float* f1w2; const float* norm_mix; const float* w_in; const float* gdn_conv;
  const float* a_log; const float* dt_bias; const float* out_gain; const float* qlat_gain; const float* kvlat_gain;
  const float* wq_up; const float* wkv_up; const float* q_norm; const float* k_norm; const float* wba; const float* wbb;
  const float* wout; const float* norm_ffn2; const float* f2w1; const float* f2w3; const float* f2w2;
  float* out; char* ws;
};

typedef const __attribute__((address_space(4))) Params* KPtr;
__device__ __forceinline__ KPtr kparams() { KPtr k = (KPtr)__builtin_amdgcn_kernarg_segment_ptr(); asm volatile("" : "+s"(k)); return k; }

__device__ __forceinline__ int tidx() { int t = threadIdx.x; asm volatile("" : "+v"(t)); return t; }
DEV float bf2f(bf16_t b) { return __uint_as_float(((unsigned)b) << 16); }
DEV unsigned pk2(float lo, float hi) { unsigned r; asm("v_cvt_pk_bf16_f32 %0, %1, %2" : "=v"(r) : "v"(lo), "v"(hi)); return r; }
DEV bf16_t f2bf(float f) { return (bf16_t)(pk2(f, 0.f) & 0xffffu); }
DEV float lo_f(unsigned u) { return __uint_as_float(u << 16); }
DEV float hi_f(unsigned u) { return __uint_as_float(u & 0xffff0000u); }
DEV float siluf(float x) { return x / (1.f + __expf(-x)); }
DEV float sigm(float x) { return 1.f / (1.f + __expf(-x)); }
DEV float wsum(float v) {
#pragma unroll
  for (int o = 32; o >= 1; o >>= 1) v += __shfl_xor(v, o);
  return v;
}
DEV bf16x8 mk8(u32x2 lo, u32x2 hi) { u32x4 t; t.x = lo.x; t.y = lo.y; t.z = hi.x; t.w = hi.y; return __builtin_bit_cast(bf16x8, t); }
DEV bf16x8 cvt8(const f32x16& v, int half) {
  u32x4 t;
  if (half == 0) { t.x = pk2(v[0], v[1]); t.y = pk2(v[2], v[3]); t.z = pk2(v[4], v[5]); t.w = pk2(v[6], v[7]); }
  else { t.x = pk2(v[8], v[9]); t.y = pk2(v[10], v[11]); t.z = pk2(v[12], v[13]); t.w = pk2(v[14], v[15]); }
  return __builtin_bit_cast(bf16x8, t);
}
DEV f32x16 mfma32(bf16x8 a, bf16x8 b, f32x16 c) { return __builtin_amdgcn_mfma_f32_32x32x16_bf16(a, b, c, 0, 0, 0); }
DEV f32x16 zero16() { f32x16 z; for (int i = 0; i < 16; ++i) z[i] = 0.f; return z; }

constexpr int HTB = 128 * 64 * 2;
DEV int lds_byte(int r, int c) { int st = (r >> 4) * 2 + (c >> 5), rr = r & 15, cc = c & 31, ob = rr * 64 + cc * 2; return st * 1024 + (ob ^ (((ob >> 9) & 1) << 5)); }
DEV void stage_rc(int b, int& R, int& C) { int st = b >> 10, sb = b & 1023, swz = sb ^ (((sb >> 9) & 1) << 5); R = (st >> 1) * 16 + (swz >> 6); C = (st & 1) * 32 + ((swz & 63) >> 1); }

enum { E_SWIGLU = 0, E_RESID = 1, E_INPROJ = 2, E_MERGE1 = 3, E_MERGE2 = 4, E_BF16 = 5 };
struct EpiArgs {
  bf16_t* o0; bf16_t* o1; bf16_t* o2; float* f0; const float* f1; const float* gate; const bf16_t* g; float gs; int ldc;
};

DEV void stage(char* P, const bf16_t* base, int ld, int br, int kt, const int (&vo)[2]) {
  const char* g = (const char*)(base + (size_t)br * ld + kt * 64);
#pragma unroll
  for (int i = 0; i < 2; ++i)
    __builtin_amdgcn_global_load_lds((const unsigned*)(g + vo[i]), (LAS unsigned*)(P + tidx() * 16 + i * 8192), 16, 0, 0);
}

template <int EPI>
__device__ __forceinline__ void gemm_tile(const bf16_t* __restrict__ A, int lda, const bf16_t* __restrict__ Bt, int ldb, int K, int brow, int bcol,
                          const EpiArgs& ea, char* shm) {
#define SA(b, h) (shm + ((b) * 2 + (h)) * HTB)
#define SB(b, h) (shm + (4 + (b) * 2 + (h)) * HTB)
#define LDA(dst, b, h) _Pragma("unroll") for (int m = 0; m < 4; ++m) _Pragma("unroll") for (int k = 0; k < 2; ++k) \
    dst[m][k] = *reinterpret_cast<const bf16x8*>(SA(b, h) + lds_byte(wr * 64 + m * 16 + fr, k * 32 + fq * 8))
#define LDB(dst, b, h) _Pragma("unroll") for (int n = 0; n < 2; ++n) _Pragma("unroll") for (int k = 0; k < 2; ++k) \
    dst[n][k] = *reinterpret_cast<const bf16x8*>(SB(b, h) + lds_byte(wc * 32 + n * 16 + fr, k * 32 + fq * 8))
#define MMA(ai, bj, At_, Bt_) do { __builtin_amdgcn_s_setprio(1); \
    _Pragma("unroll") for (int m = 0; m < 4; ++m) _Pragma("unroll") for (int n = 0; n < 2; ++n) _Pragma("unroll") for (int k = 0; k < 2; ++k) \
      acc[ai][bj][m][n] = __builtin_amdgcn_mfma_f32_16x16x32_bf16(Bt_[n][k], At_[m][k], acc[ai][bj][m][n], 0, 0, 0); \
    __builtin_amdgcn_s_setprio(0); } while (0)
#define WAIT_V(n) asm volatile("s_waitcnt vmcnt(" #n ")" ::: "memory")
#define WAIT_L(n) asm volatile("s_waitcnt lgkmcnt(" #n ")" ::: "memory")
#define BAR __builtin_amdgcn_s_barrier()
#define SCHED __builtin_amdgcn_sched_barrier(0)
  const int wid = tidx() >> 6, lane = tidx() & 63, wr = wid >> 2, wc = wid & 3, fr = lane & 15, fq = lane >> 4;
  f32x4 acc[2][2][4][2];
#pragma unroll
  for (int a = 0; a < 2; ++a)
#pragma unroll
    for (int b = 0; b < 2; ++b)
#pragma unroll
      for (int m = 0; m < 4; ++m)
#pragma unroll
        for (int n = 0; n < 2; ++n) acc[a][b][m][n] = (f32x4){0.f, 0.f, 0.f, 0.f};
  bf16x8 At[4][2], B0[2][2], B1[2][2];
  const int nt = K / 64;
  int voA[2], voB[2];
#pragma unroll
  for (int i = 0; i < 2; ++i) { int r, c; stage_rc(tidx() * 16 + i * 8192, r, c); voA[i] = (r * lda + c) * 2; voB[i] = (r * ldb + c) * 2; }
  __syncthreads();
  stage(SB(0, 0), Bt, ldb, bcol, 0, voB); stage(SA(0, 0), A, lda, brow, 0, voA);
  stage(SB(0, 1), Bt, ldb, bcol + 128, 0, voB); stage(SA(0, 1), A, lda, brow + 128, 0, voA);
  if (wr == 1) BAR;
  WAIT_V(4); BAR;
  stage(SB(1, 0), Bt, ldb, bcol, 1, voB); stage(SA(1, 0), A, lda, brow, 1, voA); stage(SB(1, 1), Bt, ldb, bcol + 128, 1, voB);
  WAIT_V(6); BAR;
  for (int t = 0; t < nt - 2; t += 2) {
    LDB(B0, 0, 0); SCHED; LDA(At, 0, 0); stage(SA(1, 1), A, lda, brow + 128, t + 1, voA);
    WAIT_L(8); BAR; WAIT_L(0); MMA(0, 0, At, B0); BAR; SCHED;
    LDB(B1, 0, 1); stage(SB(0, 0), Bt, ldb, bcol, t + 2, voB);
    BAR; WAIT_L(0); MMA(0, 1, At, B1); BAR;
    LDA(At, 0, 1); stage(SA(0, 0), A, lda, brow, t + 2, voA);
    BAR; WAIT_L(0); MMA(1, 0, At, B0); BAR; SCHED;
    stage(SB(0, 1), Bt, ldb, bcol + 128, t + 2, voB);
    WAIT_V(6); BAR; MMA(1, 1, At, B1); BAR;
    LDB(B0, 1, 0); SCHED; LDA(At, 1, 0); stage(SA(0, 1), A, lda, brow + 128, t + 2, voA);
    WAIT_L(8); BAR; WAIT_L(0); MMA(0, 0, At, B0); BAR; SCHED;
    LDB(B1, 1, 1); stage(SB(1, 0), Bt, ldb, bcol, t + 3, voB);
    BAR; WAIT_L(0); MMA(0, 1, At, B1); BAR;
    LDA(At, 1, 1); stage(SA(1, 0), A, lda, brow, t + 3, voA);
    BAR; WAIT_L(0); MMA(1, 0, At, B0); BAR; SCHED;
    stage(SB(1, 1), Bt, ldb, bcol + 128, t + 3, voB);
    WAIT_V(6); BAR; MMA(1, 1, At, B1); BAR;
  }
  { LDB(B0, 0, 0); LDA(At, 0, 0); stage(SA(1, 1), A, lda, brow + 128, nt - 1, voA);
    BAR; WAIT_L(0); MMA(0, 0, At, B0); BAR;
    LDB(B1, 0, 1); BAR; WAIT_L(0); MMA(0, 1, At, B1); BAR;
    LDA(At, 0, 1); WAIT_V(4); BAR; WAIT_L(0); MMA(1, 0, At, B0); MMA(1, 1, At, B1); BAR; }
  { LDB(B0, 1, 0); LDA(At, 1, 0); WAIT_V(2); BAR; WAIT_L(0); MMA(0, 0, At, B0); BAR;
    LDB(B1, 1, 1); WAIT_V(0); BAR; WAIT_L(0); MMA(0, 1, At, B1); BAR;
    LDA(At, 1, 1); BAR; WAIT_L(0); MMA(1, 0, At, B0); MMA(1, 1, At, B1); BAR; }
  if (wr == 0) BAR;
#pragma unroll
  for (int ai = 0; ai < 2; ++ai)
#pragma unroll
    for (int m = 0; m < 4; ++m) {
      const int row = brow + ai * 128 + wr * 64 + m * 16 + fr;
      if (EPI == E_SWIGLU) {
#pragma unroll
        for (int n = 0; n < 2; ++n) {
          const int col = (bcol >> 1) + wc * 32 + n * 16 + 4 * fq;
          f32x4 g = acc[ai][0][m][n], u = acc[ai][1][m][n];
          u32x2 o; o.x = pk2(siluf(g[0]) * u[0], siluf(g[1]) * u[1]); o.y = pk2(siluf(g[2]) * u[2], siluf(g[3]) * u[3]);
          *(u32x2*)(ea.o0 + (size_t)row * 2816 + col) = o;
        }
      } else {
#pragma unroll
        for (int bj = 0; bj < 2; ++bj)
#pragma unroll
          for (int n = 0; n < 2; ++n) {
            const int col = bcol + bj * 128 + wc * 32 + n * 16 + 4 * fq;
            f32x4 v = acc[ai][bj][m][n];
            if (EPI == E_RESID) {
              const int b = row >> 12;
              f32x4 gt = *(const f32x4*)(ea.gate + (size_t)b * 9216 + col);
              f32x4 r = *(const f32x4*)(ea.f1 + (size_t)row * 1024 + col);
              f32x4 o;
#pragma unroll
              for (int j = 0; j < 4; ++j) o[j] = r[j] + ea.gs * (1.f + gt[j]) * v[j];
              *(f32x4*)(ea.f0 + (size_t)row * 1024 + col) = o;
            } else if (EPI == E_INPROJ) {
              bf16_t* dst;
              if (bcol < 3072) dst = ea.o0 + (size_t)row * 3072 + col;
              else if (bcol < 6144) dst = ea.o1 + (size_t)row * 3072 + (col - 3072);
              else dst = ea.o2 + (size_t)row * 768 + (col - 6144);
              u32x2 o; o.x = pk2(v[0], v[1]); o.y = pk2(v[2], v[3]);
              *(u32x2*)dst = o;
            } else if (EPI == E_MERGE1) {
              u32x2 gg = *(const u32x2*)(ea.g + (size_t)row * 3072 + 1024 + col);
              f32x4 o; o[0] = sigm(lo_f(gg.x)) * v[0]; o[1] = sigm(hi_f(gg.x)) * v[1]; o[2] = sigm(lo_f(gg.y)) * v[2]; o[3] = sigm(hi_f(gg.y)) * v[3];
              *(f32x4*)(ea.f0 + (size_t)row * 1024 + col) = o;
            } else if (EPI == E_MERGE2) {
              u32x2 gg = *(const u32x2*)(ea.g + (size_t)row * 3072 + 2048 + col);
              f32x4 t = *(const f32x4*)(ea.f1 + (size_t)row * 1024 + col);
              u32x2 o;
              o.x = pk2(t[0] + sigm(lo_f(gg.x)) * v[0], t[1] + sigm(hi_f(gg.x)) * v[1]);
              o.y = pk2(t[2] + sigm(lo_f(gg.y)) * v[2], t[3] + sigm(hi_f(gg.y)) * v[3]);
              *(u32x2*)(ea.o0 + (size_t)row * 1024 + col) = o;
            } else {
              u32x2 o; o.x = pk2(v[0], v[1]); o.y = pk2(v[2], v[3]);
              *(u32x2*)(ea.o0 + (size_t)row * ea.ldc + col) = o;
            }
          }
      }
    }
#undef SA
#undef SB
#undef LDA
#undef LDB
#undef MMA
}

DEV void tile_map(int L, int nM, int nN, int& pm, int& pn) {
  const int nwg = nM * nN;
  int wgid = L; { const int q = nwg / 8, r = nwg % 8, xcd = wgid % 8, off = wgid / 8; wgid = (xcd < r ? xcd * (q + 1) : r * (q + 1) + (xcd - r) * q) + off; }
  const int nig = 8 * nN, gid = wgid / nig, fm = gid * 8, gsz = (nM - fm) < 8 ? (nM - fm) : 8;
  pm = fm + ((wgid % nig) % gsz); pn = (wgid % nig) / gsz;
}

template <int EPI>
__device__ __forceinline__ void gemm_phase(const bf16_t* A, int lda, const bf16_t* Bt, int K, int M, int N, const EpiArgs& ea, char* shm, int first, int nblk) {
  const int nM = M / 256, nN = N / 256, nwg = nM * nN;
  for (int L = first; L < nwg; L += nblk) {
    int pm, pn; tile_map(L, nM, nN, pm, pn);
    gemm_tile<EPI>(A, lda, Bt, K, K, pm * 256, pn * 256, ea, shm);
  }
}

__device__ __forceinline__ void mod_phase(KPtr p, char* shm) {
  float* cond = (float*)shm;
  float* part = (float*)(shm + 32768);
  const int tid = tidx(), w = tid >> 6, lane = tid & 63;
  __syncthreads();
  for (int i = tid; i < 8192; i += NT) cond[i] = siluf(p->c[i]);
  __syncthreads();
  float* MOD = (float*)(p->ws + OFF_MOD);
  for (int it = blockIdx.x; it < 576; it += gridDim.x) {
    const int l = it / 144, n0 = (it % 144) * 64;
    const float* wp = p->ada_w + (size_t)l * 1024 * 9216 + n0 + lane;
    float a0 = 0, a1 = 0, a2 = 0, a3 = 0, a4 = 0, a5 = 0, a6 = 0, a7 = 0;
    for (int k = w * 128; k < w * 128 + 128; ++k) {
      const float wv = wp[(size_t)k * 9216];
      a0 += cond[k] * wv; a1 += cond[1024 + k] * wv; a2 += cond[2048 + k] * wv; a3 += cond[3072 + k] * wv;
      a4 += cond[4096 + k] * wv; a5 += cond[5120 + k] * wv; a6 += cond[6144 + k] * wv; a7 += cond[7168 + k] * wv;
    }
    float* pw = part + w * 512 + lane;
    pw[0] = a0; pw[64] = a1; pw[128] = a2; pw[192] = a3; pw[256] = a4; pw[320] = a5; pw[384] = a6; pw[448] = a7;
    __syncthreads();
    {
      const int b = w; float s = 0.f;
#pragma unroll
      for (int ww = 0; ww < 8; ++ww) s += part[ww * 512 + b * 64 + lane];
      MOD[((size_t)l * 8 + b) * 9216 + n0 + lane] = s + p->ada_b[l * 9216 + n0 + lane];
    }
    __syncthreads();
  }
}

__device__ __forceinline__ void rope_phase(KPtr p) {
  float* RC = (float*)(p->ws + OFF_ROPE_C); float* RS = (float*)(p->ws + OFF_ROPE_S);
  for (int i = blockIdx.x * NT + tidx(); i < 32768 * 32; i += gridDim.x * NT) {
    const int t = i >> 5, j = i & 31;
    const float inv = exp2f(-(float)j * (13.287712379549449f / 32.f));
    const float ang = (float)p->pos[t] * inv;
    const double a = (double)ang;
    const double kk = rint(a * 0.15915494309189535);
    const float r = (float)(a - kk * 6.283185307179586);
    RC[i] = __cosf(r); RS[i] = __sinf(r);
  }
}

DEV int win_col(int n) {
  if (n < 4096) return n;
  if (n < 6144) return n + 720;
  if (n < 6528) return n - 6144 + 4112;
  if (n < 6784) return n - 6528 + 4496;
  if (n < 6848) return n - 6784 + 4752;
  if (n < 6864) return n - 6848 + 4096;
  return -1;
}
__device__ __forceinline__ void wconv_phase(KPtr p, int l, char* shm, int first, int nblk) {
  float* tile = (float*)shm;
  bf16_t* WB = (bf16_t*)(p->ws + OFF_WB);
  const int tid = tidx();
  for (int it = first; it < 6992; it += nblk) {
    int m, ti = it;
    const float* s0; const float* s1 = nullptr; const float* rs = nullptr; bf16_t* dst; int N, K, ld, mode = 0;
    if (ti < 1408) { m = 0; s0 = p->f1w1 + (size_t)l * 1024 * 2816; s1 = p->f1w3 + (size_t)l * 1024 * 2816; dst = WB + WE_13A; N = 5632; K = 1024; ld = 2816; mode = 1; }
    else if ((ti -= 1408) < 704) { m = 1; s0 = p->f1w2 + (size_t)l * 2816 * 1024; dst = WB + WE_2A; N = 1024; K = 2816; ld = 1024; }
    else if ((ti -= 704) < 1728) { m = 2; s0 = p->w_in + (size_t)l * 1024 * 6864; dst = WB + WE_IN; N = 6912; K = 1024; ld = 6864; mode = 2; }
    else if ((ti -= 1728) < 144) { m = 3; s0 = p->wq_up + (size_t)l * 384 * 1536; dst = WB + WE_Q; N = 1536; K = 384; ld = 1536; rs = p->qlat_gain + l * 384; }
    else if ((ti -= 144) < 128) { m = 4; s0 = p->wkv_up + (size_t)l * 256 * 2048; dst = WB + WE_KV; N = 2048; K = 256; ld = 2048; rs = p->kvlat_gain + l * 256; }
    else if ((ti -= 128) < 256) { m = 5; s0 = p->wba + (size_t)l * 1048576; dst = WB + WE_A; N = 1024; K = 1024; ld = 1024; }
    else if ((ti -= 256) < 256) { m = 6; s0 = p->wbb + (size_t)l * 1048576; dst = WB + WE_B; N = 1024; K = 1024; ld = 1024; }
    else if ((ti -= 256) < 256) { m = 7; s0 = p->wout + (size_t)l * 1048576; dst = WB + WE_O; N = 1024; K = 1024; ld = 1024; }
    else if ((ti -= 256) < 1408) { m = 8; s0 = p->f2w1 + (size_t)l * 1024 * 2816; s1 = p->f2w3 + (size_t)l * 1024 * 2816; dst = WB + WE_13B; N = 5632; K = 1024; ld = 2816; mode = 1; }
    else { ti -= 1408; m = 9; s0 = p->f2w2 + (size_t)l * 2816 * 1024; dst = WB + WE_2B; N = 1024; K = 2816; ld = 1024; }
    (void)m; (void)N;
    const int nkt = K / 64, n0 = (ti / nkt) * 64, k0 = (ti % nkt) * 64;
    __syncthreads();
    {
      const int n = n0 + (tid & 63);
      const float* src = s0; int col = n;
      if (mode == 1) { src = ((n & 255) < 128) ? s0 : s1; col = (n >> 8) * 128 + (n & 127); }
      else if (mode == 2) col = win_col(n);
#pragma unroll
      for (int i = 0; i < 8; ++i) {
        const int kl = (tid >> 6) + 8 * i, k = k0 + kl;
        float v = (col >= 0) ? src[(size_t)k * ld + col] : 0.f;
        if (rs) v *= rs[k];
        tile[kl * 65 + (tid & 63)] = v;
      }
    }
    __syncthreads();
    {
      const int nl = tid >> 3, ks = (tid & 7) * 8;
      u32x4 o;
      o.x = pk2(tile[(ks + 0) * 65 + nl], tile[(ks + 1) * 65 + nl]); o.y = pk2(tile[(ks + 2) * 65 + nl], tile[(ks + 3) * 65 + nl]);
      o.z = pk2(tile[(ks + 4) * 65 + nl], tile[(ks + 5) * 65 + nl]); o.w = pk2(tile[(ks + 6) * 65 + nl], tile[(ks + 7) * 65 + nl]);
      *(u32x4*)(dst + (size_t)(n0 + nl) * K + k0 + ks) = o;
    }
  }
}

__device__ __forceinline__ void norm_phase(const float* x, const float* gain, const float* shift, const float* scale, bf16_t* H) {
  const int w = tidx() >> 6, lane = tidx() & 63;
  for (int row = blockIdx.x * 8 + w; row < 32768; row += gridDim.x * 8) {
    const float* xr = x + (size_t)row * 1024; const int b = row >> 12;
    f32x4 v[4]; float ss = 0.f;
#pragma unroll
    for (int j = 0; j < 4; ++j) { v[j] = *(const f32x4*)(xr + j * 256 + lane * 4); ss += v[j][0] * v[j][0] + v[j][1] * v[j][1] + v[j][2] * v[j][2] + v[j][3] * v[j][3]; }
    ss = wsum(ss);
    const float rstd = rsqrtf(ss * (1.f / 1024.f) + 1e-6f);
#pragma unroll
    for (int j = 0; j < 4; ++j) {
      const int c = j * 256 + lane * 4;
      f32x4 g = *(const f32x4*)(gain + c), sc = *(const f32x4*)(scale + (size_t)b * 9216 + c), sh = *(const f32x4*)(shift + (size_t)b * 9216 + c);
      float o0 = v[j][0] * rstd * g[0] * (1.f + sc[0]) + sh[0], o1 = v[j][1] * rstd * g[1] * (1.f + sc[1]) + sh[1];
      float o2 = v[j][2] * rstd * g[2] * (1.f + sc[2]) + sh[2], o3 = v[j][3] * rstd * g[3] * (1.f + sc[3]) + sh[3];
      u32x2 o; o.x = pk2(o0, o1); o.y = pk2(o2, o3);
      *(u32x2*)(H + (size_t)row * 1024 + c) = o;
    }
  }
}

__device__ __forceinline__ void gdn_prep_item(KPtr p, int l, int item, char* shm) {
  const int tid = tidx(), w = tid >> 6, lane = tid & 63, l32 = lane & 31, hh = lane >> 5;
  const int c = item & 63, h = (item >> 6) & 7, bl = item >> 9;
  const int tl0 = bl * 4096 + c * 64;
  const bf16_t* QKV = (const bf16_t*)(p->ws + OFF_QKV);
  const bf16_t* LAT = (const bf16_t*)(p->ws + OFF_LAT);
  bf16_t* rec = (bf16_t*)(p->ws + OFF_GDN) + (size_t)item * REC;
  char* Kn = shm; char* Qn = shm + 17408; char* VBt = shm + 34816; char* KBGt = shm + 53248; char* KDt = shm + 71680;
  float* Mf = (float*)(shm + 90112); char* Tb = shm + 107520; char* QKb = shm + 116736;
  float* gc = (float*)(shm + 125952); float* bet = gc + 64; float* eg = gc + 128; float* kds = gc + 192;
  __syncthreads();
  if (tid < 64) {
    const int tl = tl0 + tid;
    const float braw = bf2f(LAT[(size_t)tl * 768 + 704 + h]), araw = bf2f(LAT[(size_t)tl * 768 + 712 + h]);
    const float xx = araw + p->dt_bias[l * 8 + h];
    const float sp = (xx > 20.f) ? xx : log1pf(expf(xx));
    float g = -expf(p->a_log[l * 8 + h]) * sp;
#pragma unroll
    for (int o = 1; o < 64; o <<= 1) { float n = __shfl_up(g, o); if (lane >= o) g += n; }
    const float gl = __shfl(g, 63);
    gc[tid] = g; bet[tid] = sigm(braw); eg[tid] = expf(g); kds[tid] = expf(gl - g);
    if (tid == 63) ((float*)(p->ws + OFF_GLAST))[item] = expf(g);
  }
  __syncthreads();
#pragma unroll 1
  for (int mat = 0; mat < 3; ++mat) {
    const int col = mat * 1024 + h * 128 + 2 * lane;
    f32x2 cw[4];
#pragma unroll
    for (int j = 0; j < 4; ++j) cw[j] = *(const f32x2*)(p->gdn_conv + ((size_t)l * 4 + j) * 3072 + col);
    unsigned xr[11];
#pragma unroll
    for (int i = 0; i < 11; ++i) {
      const int r = 8 * w + i - 3;
      xr[i] = (c * 64 + r >= 0) ? *(const unsigned*)(QKV + (size_t)(tl0 + r) * 3072 + col) : 0u;
    }
#pragma unroll
    for (int r = 0; r < 8; ++r) {
      float o0 = 0.f, o1 = 0.f;
#pragma unroll
      for (int j = 0; j < 4; ++j) { o0 += lo_f(xr[r + j]) * cw[j][0]; o1 += hi_f(xr[r + j]) * cw[j][1]; }
      o0 = siluf(o0); o1 = siluf(o1);
      const int row = 8 * w + r;
      if (mat < 2) {
        const float ss = wsum(o0 * o0 + o1 * o1);
        const float rs = rsqrtf(ss + 1e-6f);
        o0 *= rs; o1 *= rs;
      }
      if (mat == 0) {
        o0 *= 0.08838834764831845f; o1 *= 0.08838834764831845f;
        *(unsigned*)(Qn + row * 272 + lane * 4) = pk2(o0, o1);
      } else if (mat == 1) {
        *(unsigned*)(Kn + row * 272 + lane * 4) = pk2(o0, o1);
        const float a = bet[row] * eg[row], d = kds[row];
        *(bf16_t*)(KBGt + (2 * lane) * 144 + row * 2) = f2bf(o0 * a); *(bf16_t*)(KBGt + (2 * lane + 1) * 144 + row * 2) = f2bf(o1 * a);
        *(bf16_t*)(KDt + (2 * lane) * 144 + row * 2) = f2bf(o0 * d); *(bf16_t*)(KDt + (2 * lane + 1) * 144 + row * 2) = f2bf(o1 * d);
      } else {
        const float a = bet[row];
        *(bf16_t*)(VBt + (2 * lane) * 144 + row * 2) = f2bf(o0 * a); *(bf16_t*)(VBt + (2 * lane + 1) * 144 + row * 2) = f2bf(o1 * a);
      }
    }
  }
  __syncthreads();
  {
    const int bi = w & 3, ib = bi >> 1, jb = bi & 1; const bool isq = w >= 4;
    f32x16 acc = zero16();
    if (!(ib == 0 && jb == 1)) {
      const char* Ab = isq ? Qn : Kn;
#pragma unroll
      for (int s = 0; s < 8; ++s) {
        bf16x8 a = *(const bf16x8*)(Ab + (ib * 32 + l32) * 272 + (16 * s + 8 * hh) * 2);
        bf16x8 b = *(const bf16x8*)(Kn + (jb * 32 + l32) * 272 + (16 * s + 8 * hh) * 2);
        acc = mfma32(a, b, acc);
      }
    }
    const int j = jb * 32 + l32; const float gj = gc[j];
#pragma unroll
    for (int r = 0; r < 16; ++r) {
      const int i = ib * 32 + (r >> 2) * 8 + 4 * hh + (r & 3);
      const float dec = expf(fminf(gc[i] - gj, 0.f));
      if (isq) *(bf16_t*)(QKb + i * 144 + j * 2) = f2bf((i >= j) ? acc[r] * dec : 0.f);
      else Mf[i * 68 + j] = (i > j) ? bet[i] * acc[r] * dec : 0.f;
    }
  }
  __syncthreads();
  if (w == 0) {
    float T[64];
    int zoff; asm volatile("v_mov_b32 %0, 0" : "=v"(zoff));
    const float* Mz = Mf + zoff;
#pragma unroll
    for (int i = 0; i < 64; ++i) {
      float a = -Mf[i * 68 + lane];
#pragma unroll
      for (int j = 0; j < i; ++j) a -= Mz[i * 68 + j] * T[j];
      T[i] = a;
    }
#pragma unroll
    for (int i = 0; i < 64; ++i) *(bf16_t*)(Tb + i * 144 + lane * 2) = f2bf(T[i]);
    *(bf16_t*)(Tb + lane * 144 + lane * 2) = (bf16_t)0x3F80;
  } else {
    for (int f = w - 1; f < 40; f += 7) {
      if (f < 16) {
        const int rb = f >> 3, s = f & 7, row = rb * 32 + l32;
        const char* src = Qn + row * 272 + (16 * s + 4 * hh) * 2;
        u32x2 lo = *(const u32x2*)src, hi = *(const u32x2*)(src + 16);
        const float e = eg[row];
        u32x4 o; o.x = pk2(lo_f(lo.x) * e, hi_f(lo.x) * e); o.y = pk2(lo_f(lo.y) * e, hi_f(lo.y) * e);
        o.z = pk2(lo_f(hi.x) * e, hi_f(hi.x) * e); o.w = pk2(lo_f(hi.y) * e, hi_f(hi.y) * e);
        *(u32x4*)(rec + 8192 + (f * 64 + lane) * 8) = o;
      } else if (f < 32) {
        const int f2 = f - 16, rb = f2 >> 2, s = f2 & 3, row = rb * 32 + l32;
        const char* src = KDt + row * 144 + (16 * s + 4 * hh) * 2;
        u32x2 lo = *(const u32x2*)src, hi = *(const u32x2*)(src + 16);
        u32x4 o; o.x = lo.x; o.y = lo.y; o.z = hi.x; o.w = hi.y;
        *(u32x4*)(rec + 16384 + (f2 * 64 + lane) * 8) = o;
      } else {
        const int f3 = f - 32, rb = f3 >> 2, s = f3 & 3, row = rb * 32 + l32;
        const char* src = QKb + row * 144 + (16 * s + 4 * hh) * 2;
        u32x2 lo = *(const u32x2*)src, hi = *(const u32x2*)(src + 16);
        u32x4 o; o.x = lo.x; o.y = lo.y; o.z = hi.x; o.w = hi.y;
        *(u32x4*)(rec + 24576 + (f3 * 64 + lane) * 8) = o;
      }
    }
  }
  __syncthreads();
  {
    const int mat = w >> 2, cb = w & 3;
    const char* Bs = mat ? KBGt : VBt;
#pragma unroll
    for (int rb = 0; rb < 2; ++rb) {
      f32x16 acc = zero16();
#pragma unroll
      for (int s = 0; s < 4; ++s) {
        bf16x8 a = *(const bf16x8*)(Tb + (rb * 32 + l32) * 144 + (16 * s + 8 * hh) * 2);
        bf16x8 b = *(const bf16x8*)(Bs + (cb * 32 + l32) * 144 + (16 * s + 8 * hh) * 2);
        acc = mfma32(a, b, acc);
      }
      if (mat == 0) {
        u32x4 o0, o1;
        o0.x = pk2(acc[0], acc[1]); o0.y = pk2(acc[2], acc[3]); o0.z = pk2(acc[4], acc[5]); o0.w = pk2(acc[6], acc[7]);
        o1.x = pk2(acc[8], acc[9]); o1.y = pk2(acc[10], acc[11]); o1.z = pk2(acc[12], acc[13]); o1.w = pk2(acc[14], acc[15]);
        bf16_t* d = rec + 28672 + ((cb * 2 + rb) * 64 + lane) * 16;
        *(u32x4*)d = o0; *(u32x4*)(d + 8) = o1;
      } else {
#pragma unroll
        for (int r = 0; r < 16; ++r) {
          const int i = rb * 32 + (r >> 2) * 8 + 4 * hh + (r & 3);
          *(bf16_t*)(Kn + i * 272 + (cb * 32 + l32) * 2) = f2bf(acc[r]);
        }
      }
    }
  }
  __syncthreads();
  for (int f = w; f < 16; f += 8) {
    const int rb = f >> 3, s = f & 7, row = rb * 32 + l32;
    const char* src = Kn + row * 272 + (16 * s + 4 * hh) * 2;
    u32x2 lo = *(const u32x2*)src, hi = *(const u32x2*)(src + 16);
    u32x4 o; o.x = lo.x; o.y = lo.y; o.z = hi.x; o.w = hi.y;
    *(u32x4*)(rec + (f * 64 + lane) * 8) = o;
  }
}

__device__ __forceinline__ void gdn_scan_item(KPtr p, int l, int item, char* shm) {
  const int tid = tidx(), w = tid >> 6, lane = tid & 63, l32 = lane & 31, hh = lane >> 5;
  const int bl = item >> 3, h = item & 7;
  const bf16_t* recs = (const bf16_t*)(p->ws + OFF_GDN) + (size_t)item * 64 * REC;
  const float* glast = (const float*)(p->ws + OFF_GLAST) + item * 64;
  char* obuf = shm + 114688;
  __syncthreads();
  if (w < 4) {
    const int dvb = w;
    f32x16 S[4];
#pragma unroll
    for (int i = 0; i < 4; ++i) S[i] = zero16();
    u32x4 un[2][2];
#pragma unroll
    for (int tb = 0; tb < 2; ++tb) { const bf16_t* up = recs + 28672 + ((dvb * 2 + tb) * 64 + lane) * 16; un[tb][0] = *(const u32x4*)up; un[tb][1] = *(const u32x4*)(up + 8); }
    __syncthreads();
#pragma unroll 1
    for (int c = 0; c < 64; ++c) {
      const char* buf = shm + (c & 1) * 57344;
      u32x4 uc[2][2];
#pragma unroll
      for (int tb = 0; tb < 2; ++tb) { uc[tb][0] = un[tb][0]; uc[tb][1] = un[tb][1]; }
      if (c + 1 < 64) {
#pragma unroll
        for (int tb = 0; tb < 2; ++tb) { const bf16_t* up = recs + (size_t)(c + 1) * REC + 28672 + ((dvb * 2 + tb) * 64 + lane) * 16; un[tb][0] = *(const u32x4*)up; un[tb][1] = *(const u32x4*)(up + 8); }
      }
      const float gl = glast[c];
      bf16x8 Sb[8];
#pragma unroll
      for (int s = 0; s < 8; ++s) Sb[s] = cvt8(S[s >> 1], s & 1);
      f32x16 WS[2], O[2];
#pragma unroll
      for (int tb = 0; tb < 2; ++tb) {
        WS[tb] = zero16(); O[tb] = zero16();
#pragma unroll
        for (int s = 0; s < 8; ++s) {
          bf16x8 aw = *(const bf16x8*)(buf + ((tb * 8 + s) * 64 + lane) * 16);
          bf16x8 aq = *(const bf16x8*)(buf + 16384 + ((tb * 8 + s) * 64 + lane) * 16);
          WS[tb] = mfma32(aw, Sb[s], WS[tb]);
          O[tb] = mfma32(aq, Sb[s], O[tb]);
        }
      }
#pragma unroll
      for (int tb = 0; tb < 2; ++tb) {
        const u32x4 a = uc[tb][0], b = uc[tb][1];
        f32x16 u;
        u[0] = lo_f(a.x); u[1] = hi_f(a.x); u[2] = lo_f(a.y); u[3] = hi_f(a.y); u[4] = lo_f(a.z); u[5] = hi_f(a.z); u[6] = lo_f(a.w); u[7] = hi_f(a.w);
        u[8] = lo_f(b.x); u[9] = hi_f(b.x); u[10] = lo_f(b.y); u[11] = hi_f(b.y); u[12] = lo_f(b.z); u[13] = hi_f(b.z); u[14] = lo_f(b.w); u[15] = hi_f(b.w);
        WS[tb] = u - WS[tb];
      }
      bf16x8 Vb[4];
#pragma unroll
      for (int s2 = 0; s2 < 4; ++s2) Vb[s2] = cvt8(WS[s2 >> 1], s2 & 1);
#pragma unroll
      for (int tb = 0; tb < 2; ++tb)
#pragma unroll
        for (int s2 = 0; s2 < 4; ++s2) {
          bf16x8 a = *(const bf16x8*)(buf + 49152 + ((tb * 4 + s2) * 64 + lane) * 16);
          O[tb] = mfma32(a, Vb[s2], O[tb]);
        }
#pragma unroll
      for (int dkb = 0; dkb < 4; ++dkb) {
        S[dkb] = S[dkb] * gl;
#pragma unroll
        for (int s2 = 0; s2 < 4; ++s2) {
          bf16x8 a = *(const bf16x8*)(buf + 32768 + ((dkb * 4 + s2) * 64 + lane) * 16);
          S[dkb] = mfma32(a, Vb[s2], S[dkb]);
        }
      }
      char* ob = obuf + (c & 1) * 17408;
#pragma unroll
      for (int tb = 0; tb < 2; ++tb)
#pragma unroll
        for (int r = 0; r < 16; ++r) {
          const int t = tb * 32 + (r >> 2) * 8 + 4 * hh + (r & 3);
          *(bf16_t*)(ob + t * 272 + (dvb * 32 + l32) * 2) = f2bf(O[tb][r]);
        }
      __syncthreads();
    }
  } else {
    const int lt = tid - 256;
    const bf16_t* ZG = (const bf16_t*)(p->ws + OFF_ZG);
    bf16_t* Og = (bf16_t*)(p->ws + OFF_QKV);
    {
      const char* src = (const char*)recs;
#pragma unroll
      for (int j = 0; j < 14; ++j) *(u32x4*)(shm + (lt + 256 * j) * 16) = *(const u32x4*)(src + (lt + 256 * j) * 16);
    }
    __syncthreads();
    const int row = lt >> 2, seg = lt & 3;
    f32x4 og[8];
#pragma unroll
    for (int j = 0; j < 8; ++j) og[j] = *(const f32x4*)(p->out_gain + l * 128 + seg * 32 + j * 4);
#pragma unroll 1
    for (int c = 0; c <= 64; ++c) {
      u32x4 ld[14];
      if (c + 1 < 64) {
        const char* src = (const char*)(recs + (size_t)(c + 1) * REC);
#pragma unroll
        for (int j = 0; j < 14; ++j) ld[j] = *(const u32x4*)(src + (lt + 256 * j) * 16);
      }
      if (c >= 1) {
        const int cc = c - 1;
        const char* ob = obuf + (cc & 1) * 17408 + row * 272 + seg * 64;
        const int tl = bl * 4096 + cc * 64 + row;
        u32x4 ov[4], zv[4];
#pragma unroll
        for (int j = 0; j < 4; ++j) { ov[j] = *(const u32x4*)(ob + j * 16); zv[j] = *(const u32x4*)(ZG + (size_t)tl * 3072 + h * 128 + seg * 32 + j * 8); }
        float ss = 0.f;
#pragma unroll
        for (int j = 0; j < 4; ++j) {
          ss += lo_f(ov[j].x) * lo_f(ov[j].x) + hi_f(ov[j].x) * hi_f(ov[j].x) + lo_f(ov[j].y) * lo_f(ov[j].y) + hi_f(ov[j].y) * hi_f(ov[j].y);
          ss += lo_f(ov[j].z) * lo_f(ov[j].z) + hi_f(ov[j].z) * hi_f(ov[j].z) + lo_f(ov[j].w) * lo_f(ov[j].w) + hi_f(ov[j].w) * hi_f(ov[j].w);
        }
        ss += __shfl_xor(ss, 1); ss += __shfl_xor(ss, 2);
        const float rstd = rsqrtf(ss * (1.f / 128.f) + 1e-6f);
#pragma unroll
        for (int j = 0; j < 4; ++j) {
          const f32x4 g0 = og[2 * j], g1 = og[2 * j + 1];
          u32x4 o;
          o.x = pk2(lo_f(ov[j].x) * rstd * g0[0] * siluf(lo_f(zv[j].x)), hi_f(ov[j].x) * rstd * g0[1] * siluf(hi_f(zv[j].x)));
          o.y = pk2(lo_f(ov[j].y) * rstd * g0[2] * siluf(lo_f(zv[j].y)), hi_f(ov[j].y) * rstd * g0[3] * siluf(hi_f(zv[j].y)));
          o.z = pk2(lo_f(ov[j].z) * rstd * g1[0] * siluf(lo_f(zv[j].z)), hi_f(ov[j].z) * rstd * g1[1] * siluf(hi_f(zv[j].z)));
          o.w = pk2(lo_f(ov[j].w) * rstd * g1[2] * siluf(lo_f(zv[j].w)), hi_f(ov[j].w) * rstd * g1[3] * siluf(hi_f(zv[j].w)));
          *(u32x4*)(Og + (size_t)tl * 2048 + h * 128 + seg * 32 + j * 8) = o;
        }
      }
      if (c + 1 < 64) {
        char* dstb = shm + ((c + 1) & 1) * 57344;
#pragma unroll
        for (int j = 0; j < 14; ++j) *(u32x4*)(dstb + (lt + 256 * j) * 16) = ld[j];
      }
      if (c < 64) __syncthreads();
    }
  }
}

__device__ __forceinline__ void mla_post_item(KPtr p, int l, int half, int tt, char* shm) {
  const int tid = tidx(), w = tid >> 6, lane = tid & 63;
  const int tl0 = tt * 64, bl = tl0 >> 12, s0 = tl0 & 4095;
  const bf16_t* LAT = (const bf16_t*)(p->ws + OFF_LAT);
  bf16_t* QR = (bf16_t*)(p->ws + OFF_QR); const bf16_t* KVR = (const bf16_t*)(p->ws + OFF_KVR);
  bf16_t* KF = (bf16_t*)(p->ws + OFF_KF); bf16_t* VT = (bf16_t*)(p->ws + OFF_VT);
  const float* RC = (const float*)(p->ws + OFF_ROPE_C); const float* RS = (const float*)(p->ws + OFF_ROPE_S);
  float* rstd = (float*)shm;
  char* vt = shm + 1024 + w * 16640;
  __syncthreads();
  for (int i = 0; i < 8; ++i) {
    const int t = w * 8 + i; const bf16_t* lr = LAT + (size_t)(tl0 + t) * 768;
    float sq = 0.f, sk = 0.f;
#pragma unroll
    for (int j = 0; j < 6; ++j) { float v = bf2f(lr[lane + 64 * j]); sq += v * v; }
#pragma unroll
    for (int j = 0; j < 4; ++j) { float v = bf2f(lr[384 + lane + 64 * j]); sk += v * v; }
    sq = wsum(sq); sk = wsum(sk);
    if (lane == 0) { rstd[2 * t] = rsqrtf(sq * (1.f / 384.f) + 1e-6f); rstd[2 * t + 1] = rsqrtf(sk * (1.f / 256.f) + 1e-6f); }
  }
  __syncthreads();
  const int h = w;
  const float qn0 = p->q_norm[l * 192 + lane], qn1 = p->q_norm[l * 192 + 64 + lane], qn2 = p->q_norm[l * 192 + 128 + lane];
  const float kn0 = p->k_norm[l * 192 + lane], kn1 = p->k_norm[l * 192 + 64 + lane], kn2 = p->k_norm[l * 192 + 128 + lane];
  const float qs = 0.10411754515f;
#pragma unroll 1
  for (int t = 0; t < 64; ++t) {
    const int tl = tl0 + t; const size_t tg = (size_t)half * TH + tl;
    const float cs = RC[tg * 32 + (lane & 31)], sn = RS[tg * 32 + (lane & 31)];
    const float rq = rstd[2 * t], rkv = rstd[2 * t + 1];
    {
      bf16_t* qp = QR + (size_t)tl * 1536 + h * 192;
      float x0 = bf2f(qp[lane]) * rq, x1 = bf2f(qp[lane + 64]) * rq, x2 = bf2f(qp[lane + 128]) * rq;
      const float ss = wsum(x0 * x0 + x1 * x1 + x2 * x2);
      const float r = rsqrtf(ss * (1.f / 192.f) + 1e-6f);
      x0 *= r * qn0; x1 *= r * qn1; x2 *= r * qn2;
      const float pr = __shfl_xor(x2, 32);
      const float xr = (lane < 32) ? (x2 * cs - pr * sn) : (x2 * cs + pr * sn);
      qp[lane] = f2bf(x0 * qs); qp[lane + 64] = f2bf(x1 * qs); qp[lane + 128] = f2bf(xr * qs);
    }
    {
      const bf16_t* kp = KVR + (size_t)tl * 2048 + h * 256;
      float x0 = bf2f(kp[lane]) * rkv, x1 = bf2f(kp[lane + 64]) * rkv, x2 = bf2f(LAT[(size_t)tl * 768 + 640 + lane]);
      const float ss = wsum(x0 * x0 + x1 * x1 + x2 * x2);
      const float r = rsqrtf(ss * (1.f / 192.f) + 1e-6f);
      x0 *= r * kn0; x1 *= r * kn1; x2 *= r * kn2;
      const float pr = __shfl_xor(x2, 32);
      const float xr = (lane < 32) ? (x2 * cs - pr * sn) : (x2 * cs + pr * sn);
      bf16_t* ko = KF + (size_t)tl * 1536 + h * 192;
      ko[lane] = f2bf(x0); ko[lane + 64] = f2bf(x1); ko[lane + 128] = f2bf(xr);
      const float v0 = bf2f(kp[128 + lane]) * rkv, v1 = bf2f(kp[192 + lane]) * rkv;
      *(bf16_t*)(vt + t * 260 + lane * 2) = f2bf(v0); *(bf16_t*)(vt + t * 260 + (lane + 64) * 2) = f2bf(v1);
    }
  }
  {
    const int tp = lane & 31;
    bf16_t* vo = VT + ((size_t)(bl * 8 + h) * 128) * 4096 + s0 + 2 * tp;
#pragma unroll 4
    for (int i = 0; i < 64; ++i) {
      const int dv = 2 * i + (lane >> 5);
      const unsigned a = *(const bf16_t*)(vt + (2 * tp) * 260 + dv * 2), b = *(const bf16_t*)(vt + (2 * tp + 1) * 260 + dv * 2);
      *(unsigned*)(vo + (size_t)dv * 4096) = a | (b << 16);
    }
  }
}

__device__ __forceinline__ void attn_item(KPtr p, int bl, int h, int qb, char* shm) {
  const int tid = tidx(), w = tid >> 6, lane = tid & 63, l32 = lane & 31, hh = lane >> 5;
  const bf16_t* QR = (const bf16_t*)(p->ws + OFF_QR); const bf16_t* KF = (const bf16_t*)(p->ws + OFF_KF);
  const bf16_t* VT = (const bf16_t*)(p->ws + OFF_VT); bf16_t* Og = (bf16_t*)(p->ws + OFF_QKV);
  char* Ks = shm; char* Vs = shm + 25600;
  const int q0 = qb * 256, qrow = q0 + 32 * w + l32; const size_t tlq = (size_t)bl * 4096 + qrow;
  bf16x8 Qf[12];
#pragma unroll
  for (int s = 0; s < 12; ++s) Qf[s] = *(const bf16x8*)(QR + tlq * 1536 + h * 192 + 16 * s + 8 * hh);
  f32x16 O[4];
#pragma unroll
  for (int i = 0; i < 4; ++i) O[i] = zero16();
  float m = -INFINITY, lsum = 0.f;
  const int nkt = (qb + 1) * 4;
  const bf16_t* kbase = KF + (size_t)bl * 4096 * 1536 + h * 192;
  const bf16_t* vbase = VT + (size_t)(bl * 8 + h) * 128 * 4096;
  int krow[3], kcc[3];
#pragma unroll
  for (int j = 0; j < 3; ++j) { const int cid = tid + 512 * j; krow[j] = cid / 24; kcc[j] = cid % 24; }
  u32x4 kr[3], vr[2];
#pragma unroll
  for (int j = 0; j < 3; ++j) kr[j] = *(const u32x4*)(kbase + (size_t)krow[j] * 1536 + kcc[j] * 8);
#pragma unroll
  for (int j = 0; j < 2; ++j) { const int cid = tid + 512 * j; vr[j] = *(const u32x4*)(vbase + (size_t)(cid >> 3) * 4096 + (cid & 7) * 8); }
#pragma unroll 1
  for (int kt = 0; kt < nkt; ++kt) {
    __syncthreads();
#pragma unroll
    for (int j = 0; j < 3; ++j) *(u32x4*)(Ks + krow[j] * 400 + kcc[j] * 16) = kr[j];
#pragma unroll
    for (int j = 0; j < 2; ++j) { const int cid = tid + 512 * j; *(u32x4*)(Vs + (cid >> 3) * 136 + (cid & 7) * 16) = vr[j]; }
    __syncthreads();
    if (kt + 1 < nkt) {
#pragma unroll
      for (int j = 0; j < 3; ++j) kr[j] = *(const u32x4*)(kbase + (size_t)((kt + 1) * 64 + krow[j]) * 1536 + kcc[j] * 8);
#pragma unroll
      for (int j = 0; j < 2; ++j) { const int cid = tid + 512 * j; vr[j] = *(const u32x4*)(vbase + (size_t)(cid >> 3) * 4096 + (kt + 1) * 64 + (cid & 7) * 8); }
    }
    if (64 * kt <= q0 + 32 * w + 31) {
      f32x16 s0 = zero16(), s1 = zero16();
#pragma unroll
      for (int s = 0; s < 12; ++s) {
        bf16x8 k0 = *(const bf16x8*)(Ks + l32 * 400 + (16 * s + 8 * hh) * 2);
        bf16x8 k1 = *(const bf16x8*)(Ks + (32 + l32) * 400 + (16 * s + 8 * hh) * 2);
        s0 = mfma32(k0, Qf[s], s0); s1 = mfma32(k1, Qf[s], s1);
      }
      if (64 * kt + 63 > q0 + 32 * w) {
#pragma unroll
        for (int r = 0; r < 16; ++r) {
          const int key = 64 * kt + (r >> 2) * 8 + 4 * hh + (r & 3);
          if (key > qrow) s0[r] = -INFINITY;
          if (key + 32 > qrow) s1[r] = -INFINITY;
        }
      }
      float tmax = s0[0];
#pragma unroll
      for (int r = 1; r < 16; ++r) tmax = fmaxf(tmax, s0[r]);
#pragma unroll
      for (int r = 0; r < 16; ++r) tmax = fmaxf(tmax, s1[r]);
      tmax = fmaxf(tmax, __shfl_xor(tmax, 32));
      const float mnew = fmaxf(m, tmax);
      const float alpha = __builtin_amdgcn_exp2f(m - mnew);
      m = mnew;
      float ps = 0.f;
#pragma unroll
      for (int r = 0; r < 16; ++r) { s0[r] = __builtin_amdgcn_exp2f(s0[r] - mnew); s1[r] = __builtin_amdgcn_exp2f(s1[r] - mnew); ps += s0[r] + s1[r]; }
      lsum = lsum * alpha + ps;
#pragma unroll
      for (int i = 0; i < 4; ++i) O[i] = O[i] * alpha;
      bf16x8 Pb[4];
      Pb[0] = cvt8(s0, 0); Pb[1] = cvt8(s0, 1); Pb[2] = cvt8(s1, 0); Pb[3] = cvt8(s1, 1);
#pragma unroll
      for (int dvb = 0; dvb < 4; ++dvb)
#pragma unroll
        for (int s2 = 0; s2 < 4; ++s2) {
          const char* va = Vs + (dvb * 32 + l32) * 136 + (16 * s2 + 4 * hh) * 2;
          bf16x8 a = mk8(*(const u32x2*)va, *(const u32x2*)(va + 16));
          O[dvb] = mfma32(a, Pb[s2], O[dvb]);
        }
    }
  }
  lsum += __shfl_xor(lsum, 32);
  const float inv = 1.f / lsum;
  bf16_t* op = Og + tlq * 2048 + 1024 + h * 128;
#pragma unroll
  for (int dvb = 0; dvb < 4; ++dvb)
#pragma unroll
    for (int r4 = 0; r4 < 4; ++r4) {
      u32x2 o; o.x = pk2(O[dvb][4 * r4] * inv, O[dvb][4 * r4 + 1] * inv); o.y = pk2(O[dvb][4 * r4 + 2] * inv, O[dvb][4 * r4 + 3] * inv);
      *(u32x2*)(op + dvb * 32 + r4 * 8 + 4 * hh) = o;
    }
}

#define P (kparams())
#define WSP(off) (P->ws + (off))
#define WBP(e) ((bf16_t*)(P->ws + OFF_WB) + (e))
#define MODP(l, j) ((const float*)(P->ws + OFF_MOD) + (size_t)(l) * 8 * 9216 + (j) * 1024)
__global__ void __launch_bounds__(NT) mega(Params pin) {
  extern __shared__ __attribute__((aligned(16))) char shm[];
  cg::grid_group grid = cg::this_grid();
  const int bid = blockIdx.x, nb = gridDim.x;
  int* s_item = (int*)(shm + LDS_BYTES - 64);

  mod_phase(P, shm);
  rope_phase(P);
  wconv_phase(P, 0, shm, bid, nb);
  grid.sync();

#pragma unroll 1
  for (int l = 0; l < 4; ++l) {
    if (l > 0) wconv_phase(P, l, shm, bid, nb);
    norm_phase((l == 0) ? P->x : P->out, P->norm_ffn1 + l * 1024, MODP(l, 0), MODP(l, 1), (bf16_t*)WSP(OFF_H));
    grid.sync();
    { EpiArgs ea{}; ea.o0 = (bf16_t*)WSP(OFF_ACT);
      gemm_phase<E_SWIGLU>((const bf16_t*)WSP(OFF_H), 1024, WBP(WE_13A), 1024, 32768, 5632, ea, shm, bid, nb); }
    grid.sync();
    { EpiArgs ea{}; ea.f0 = P->out; ea.f1 = (l == 0) ? P->x : P->out; ea.gate = MODP(l, 2); ea.gs = 0.5f;
      gemm_phase<E_RESID>((const bf16_t*)WSP(OFF_ACT), 2816, WBP(WE_2A), 2816, 32768, 1024, ea, shm, bid, nb); }
    grid.sync();
    norm_phase(P->out, P->norm_mix + l * 1024, MODP(l, 3), MODP(l, 4), (bf16_t*)WSP(OFF_H));
    grid.sync();
#pragma unroll 1
    for (int half = 0; half < 2; ++half) {
      { EpiArgs ea{}; ea.o0 = (bf16_t*)WSP(OFF_QKV); ea.o1 = (bf16_t*)WSP(OFF_ZG); ea.o2 = (bf16_t*)WSP(OFF_LAT);
        gemm_phase<E_INPROJ>((const bf16_t*)WSP(OFF_H) + (size_t)half * TH * 1024, 1024, WBP(WE_IN), 1024, TH, 6912, ea, shm, bid, nb); }
      grid.sync();
      { EpiArgs ea{}; ea.o0 = (bf16_t*)WSP(OFF_QR); ea.ldc = 1536;
        gemm_phase<E_BF16>((const bf16_t*)WSP(OFF_LAT), 768, WBP(WE_Q), 384, TH, 1536, ea, shm, bid, nb); }
      { EpiArgs eb{}; eb.o0 = (bf16_t*)WSP(OFF_KVR); eb.ldc = 2048;
        gemm_phase<E_BF16>((const bf16_t*)WSP(OFF_LAT) + 384, 768, WBP(WE_KV), 256, TH, 2048, eb, shm, (bid + 128) % nb, nb); }
#pragma unroll 1
      for (int it = bid; it < 2048; it += nb) gdn_prep_item(P, l, it, shm);
      grid.sync();
#pragma unroll 1
      for (int it = bid; it < 256; it += nb) mla_post_item(P, l, half, it, shm);
      grid.sync();
      {
#pragma unroll 1
        while (true) {
          __syncthreads();
          if (tidx() == 0) *s_item = (int)atomicAdd((unsigned*)WSP(OFF_CTR) + (l * 2 + half) * 16, 1u);
          __syncthreads();
          const int item = *s_item;
          if (item >= 32 + 512) break;
          if (item < 32) gdn_scan_item(P, l, item, shm);
          else { const int a = item - 32; attn_item(P, a & 3, (a >> 2) & 7, 15 - (a >> 5), shm); }
        }
      }
      grid.sync();
      { EpiArgs ea{}; ea.f0 = (float*)WSP(OFF_GDN); ea.g = (const bf16_t*)WSP(OFF_ZG);
        gemm_phase<E_MERGE1>((const bf16_t*)WSP(OFF_QKV), 2048, WBP(WE_A), 1024, TH, 1024, ea, shm, bid, nb); }
      grid.sync();
      { EpiArgs ea{}; ea.o0 = (bf16_t*)WSP(OFF_H) + (size_t)half * TH * 1024; ea.f1 = (const float*)WSP(OFF_GDN); ea.g = (const bf16_t*)WSP(OFF_ZG);
        gemm_phase<E_MERGE2>((const bf16_t*)WSP(OFF_QKV) + 1024, 2048, WBP(WE_B), 1024, TH, 1024, ea, shm, bid, nb); }
      grid.sync();
    }
    { EpiArgs ea{}; ea.f0 = P->out; ea.f1 = P->out; ea.gate = MODP(l, 5); ea.gs = 1.0f;
      gemm_phase<E_RESID>((const bf16_t*)WSP(OFF_H), 1024, WBP(WE_O), 1024, 32768, 1024, ea, shm, bid, nb); }
    grid.sync();
    norm_phase(P->out, P->norm_ffn2 + l * 1024, MODP(l, 6), MODP(l, 7), (bf16_t*)WSP(OFF_H));
    grid.sync();
    { EpiArgs ea{}; ea.o0 = (bf16_t*)WSP(OFF_ACT);
      gemm_phase<E_SWIGLU>((const bf16_t*)WSP(OFF_H), 1024, WBP(WE_13B), 1024, 32768, 5632, ea, shm, bid, nb); }
    grid.sync();
    { EpiArgs ea{}; ea.f0 = P->out; ea.f1 = P->out; ea.gate = MODP(l, 8); ea.gs = 0.5f;
      gemm_phase<E_RESID>((const bf16_t*)WSP(OFF_ACT), 2816, WBP(WE_2B), 2816, 32768, 1024, ea, shm, bid, nb); }
    grid.sync();
  }
}

extern "C" void kernel_launch(void* const* d_in, const int* in_sizes, int n_in, void* d_out, int out_size, void* d_ws, size_t ws_size,
                              hipStream_t stream) {
  static int grid_blocks = 0;
  if (!grid_blocks) {
    if (ws_size < WS_END) { fprintf(stderr, "kernel_launch: workspace too small: %zu < %zu\n", ws_size, (size_t)WS_END); grid_blocks = -1; return; }
    int dev = 0, cus = 0, per_cu = 0;
    hipGetDevice(&dev);
    hipDeviceGetAttribute(&cus, hipDeviceAttributeMultiprocessorCount, dev);
    hipFuncSetAttribute((const void*)mega, hipFuncAttributeMaxDynamicSharedMemorySize, LDS_BYTES);
    hipOccupancyMaxActiveBlocksPerMultiprocessor(&per_cu, (const void*)mega, NT, LDS_BYTES);
    if (per_cu < 1) per_cu = 1;
    grid_blocks = cus * per_cu;
  }
  if (grid_blocks < 0) return;
  Params p{};
  const float** pp = (const float**)&p;
  for (int i = 0; i < 28; ++i) pp[i] = (const float*)d_in[i];
  p.out = (float*)d_out; p.ws = (char*)d_ws;
  hipMemsetAsync((char*)d_ws + OFF_CTR, 0, 4096, stream);
  void* args[] = {&p};
  hipError_t e = hipLaunchCooperativeKernel((const void*)mega, dim3(grid_blocks), dim3(NT), args, LDS_BYTES, stream);
  if (e != hipSuccess) fprintf(stderr, "cooperative launch failed: %s (grid %d)\n", hipGetErrorString(e), grid_blocks);
}
```
